# Optimizing an MI355X kernel written in HIP

```python
import math
import jax, jax.numpy as jnp
from jax import lax
import numpy as np

D_MODEL = 1024
BATCH = 2
SEQ = 8192
DEPTH = 2

N_Q_HEADS = 16
N_KV_HEADS = 2
HEAD_DIM = 64
Q_GROUP = N_Q_HEADS // N_KV_HEADS
ATTN_WIDTH = N_Q_HEADS * HEAD_DIM
KV_WIDTH = N_KV_HEADS * HEAD_DIM
WINDOW = 128
BLOCK = 128
NEG_INF = -1e30
NUM_BUCKETS = 32
MAX_DISTANCE = 128
POOL_WINDOWS = (2, 4, 8, 16)
N_POOL_GROUPS = 4
POOL_WIDTH = D_MODEL
POOL_GROUP_WIDTH = POOL_WIDTH // N_POOL_GROUPS
DEEPNORM_ALPHA = (2 * DEPTH) ** 0.25
DEEPNORM_BETA = (8 * DEPTH) ** -0.25
LN_EPS = 1e-5
SPLITS = (ATTN_WIDTH, KV_WIDTH, KV_WIDTH, ATTN_WIDTH, POOL_WIDTH, POOL_WIDTH, D_MODEL, D_MODEL)
IN_WIDTH = sum(SPLITS)

kernel_name = "hybrid_swa_sink_pool_deepnorm_adaln"


def layer_norm(x, gain, bias):
    xf = x.astype(jnp.float32)
    mu = jnp.mean(xf, axis=-1, keepdims=True)
    var = jnp.mean(jnp.square(xf - mu), axis=-1, keepdims=True)
    y = (xf - mu) * lax.rsqrt(var + LN_EPS)
    return (y * gain.astype(jnp.float32) + bias.astype(jnp.float32)).astype(x.dtype)


def t5_causal_bucket(dist):
    max_exact = NUM_BUCKETS // 2
    is_small = dist < max_exact
    d = jnp.maximum(dist, 1).astype(jnp.float32)
    large = max_exact + (jnp.log(d / max_exact) / math.log(MAX_DISTANCE / max_exact)
                         * (NUM_BUCKETS - max_exact)).astype(jnp.int32)
    large = jnp.minimum(large, NUM_BUCKETS - 1)
    return jnp.where(is_small, dist, large)


def band_structure(n_blocks, rel_bias):
    q_loc = jnp.arange(BLOCK)[:, None]
    k_loc = jnp.arange(2 * BLOCK)[None, :]
    dist = q_loc + BLOCK - k_loc
    in_window = (dist >= 0) & (dist < WINDOW)
    key_exists = (jnp.arange(n_blocks)[:, None, None] > 0) | (k_loc[None] >= BLOCK)
    mask = in_window[None] & key_exists
    bucket = t5_causal_bucket(jnp.maximum(dist, 0))
    bias = rel_bias.astype(jnp.float32)[bucket]
    bias = jnp.transpose(bias, (2, 0, 1)).reshape(N_KV_HEADS, Q_GROUP, BLOCK, 2 * BLOCK)
    return mask, bias


def sliding_window_sink_attention(q, k, v, sinks, bias, mask):
    B, S, _ = q.shape
    nb = S // BLOCK
    qb = q.reshape(B, nb, BLOCK, N_KV_HEADS, Q_GROUP, HEAD_DIM)

    def band(t):
        t = t.reshape(B, S, N_KV_HEADS, HEAD_DIM)
        t = jnp.pad(t, ((0, 0), (BLOCK, 0), (0, 0), (0, 0)))
        t = t.reshape(B, nb + 1, BLOCK, N_KV_HEADS, HEAD_DIM)
        return jnp.concatenate([t[:, :-1], t[:, 1:]], axis=2)

    kb, vb = band(k), band(v)
    logits = jnp.einsum('bnqhgd,bnkhd->bnhgqk', qb, kb).astype(jnp.float32) * (HEAD_DIM ** -0.5) + bias
    logits = jnp.where(mask[None, :, None, None], logits, NEG_INF)
    sink = jnp.broadcast_to(sinks.astype(jnp.float32).reshape(N_KV_HEADS, Q_GROUP, 1, 1),
                            logits.shape[:-1] + (1,))
    probs = jax.nn.softmax(jnp.concatenate([logits, sink], axis=-1), axis=-1)[..., :-1]
    out = jnp.einsum('bnhgqk,bnkhd->bnqhgd', probs.astype(v.dtype), vb)
    return out.reshape(B, S, ATTN_WIDTH)


def multiscale_causal_pool(u):
    B, S, _ = u.shape
    ug = u.reshape(B, S, N_POOL_GROUPS, POOL_GROUP_WIDTH).astype(jnp.float32)
    cs = jnp.concatenate([jnp.zeros((B, 1, N_POOL_GROUPS, POOL_GROUP_WIDTH), jnp.float32),
                          jnp.cumsum(ug, axis=1)], axis=1)
    outs = []
    for gi, w in enumerate(POOL_WINDOWS):
        csg = cs[:, :, gi]
        lo = jnp.pad(csg, ((0, 0), (w - 1, 0), (0, 0)))[:, :S]
        count = jnp.minimum(jnp.arange(1, S + 1), w).astype(jnp.float32)[None, :, None]
        outs.append((csg[:, 1:] - lo) / count - ug[:, :, gi])
    return jnp.stack(outs, axis=2).astype(u.dtype)


def setup_inputs(seed: int = 0) -> dict:
    key = jax.random.key(seed)
    ks = jax.random.split(key, 16)
    f32 = jnp.float32
    n = lambda k, shape: jax.random.normal(k, shape, f32)
    return {
        "x": n(ks[0], (BATCH, SEQ, D_MODEL)),
        "c": n(ks[1], (BATCH, D_MODEL)),
        "rel_bias": 0.5 * n(ks[2], (NUM_BUCKETS, N_Q_HEADS)),
        "w_ada": 0.1 * D_MODEL ** -0.5 * n(ks[3], (DEPTH, D_MODEL, 3 * D_MODEL)),
        "b_ada": 0.01 * n(ks[4], (DEPTH, 3 * D_MODEL)),
        "w_in": D_MODEL ** -0.5 * n(ks[5], (DEPTH, D_MODEL, IN_WIDTH)),
        "sinks": n(ks[6], (DEPTH, N_Q_HEADS)),
        "w_pool_mix": POOL_GROUP_WIDTH ** -0.5 * n(ks[7], (DEPTH, N_POOL_GROUPS, POOL_GROUP_WIDTH, POOL_GROUP_WIDTH)),
        "pool_scale": 1.0 + 0.1 * n(ks[8], (DEPTH, POOL_WIDTH)),
        "w_attn_proj": DEEPNORM_BETA * ATTN_WIDTH ** -0.5 * n(ks[9], (DEPTH, ATTN_WIDTH, D_MODEL)),
        "w_pool_proj": DEEPNORM_BETA * POOL_WIDTH ** -0.5 * n(ks[10], (DEPTH, POOL_WIDTH, D_MODEL)),
        "w_out": DEEPNORM_BETA * D_MODEL ** -0.5 * n(ks[11], (DEPTH, D_MODEL, D_MODEL)),
        "ln_gain": 1.0 + 0.02 * n(ks[12], (DEPTH, D_MODEL)),
        "ln_bias": 0.02 * n(ks[13], (DEPTH, D_MODEL)),
    }


def reference(x, c, rel_bias, w_ada, b_ada, w_in, sinks, w_pool_mix, pool_scale,
              w_attn_proj, w_pool_proj, w_out, ln_gain, ln_bias):
    B, S, _ = x.shape
    mask, bias = band_structure(S // BLOCK, rel_bias)
    offsets = [int(o) for o in np.cumsum(SPLITS)[:-1]]
    for l in range(DEPTH):
        mod = jax.nn.silu(c) @ w_ada[l] + b_ada[l]
        shift, scale, gate = jnp.split(mod, 3, axis=-1)
        u = x * (1.0 + scale[:, None, :]) + shift[:, None, :]
        h = u @ w_in[l]
        q, k, v, a_gate, p_in, p_gate, m_a, m_p = jnp.split(h, offsets, axis=-1)
        a = sliding_window_sink_attention(q, k, v, sinks[l], bias, mask) * jax.nn.silu(a_gate)
        a = a @ w_attn_proj[l]
        p = jnp.einsum('bsgc,gcd->bsgd', multiscale_causal_pool(p_in), w_pool_mix[l]).reshape(B, S, POOL_WIDTH)
        p = (p * pool_scale[l]) * jax.nn.silu(p_gate)
        p = p @ w_pool_proj[l]
        y = jax.nn.sigmoid(m_a) * a + jax.nn.sigmoid(m_p) * p
        y = (y @ w_out[l]) * (1.0 + gate[:, None, :])
        x = layer_norm(DEEPNORM_ALPHA * x + y, ln_gain[l], ln_bias[l])
    return x
```

```cpp
#include <hip/hip_runtime.h>
#include <cstdio>
#include <cstdint>
namespace pg8 {
#define PG8_LAS __attribute__((address_space(3)))
typedef unsigned short bf16_t;
typedef short bf16x8 __attribute__((ext_vector_type(8)));
typedef float f32x4 __attribute__((ext_vector_type(4)));
typedef unsigned u32x4 __attribute__((ext_vector_type(4)));
constexpr int BM = 256, BK = 64, HALF = 128, HTB = HALF * BK * 2  , STAGE_BYTES = 8 * HTB, NXCD = 8, WGM = 8;

__host__ __device__ __forceinline__ int lds_byte(int r, int c) { const int st = (r >> 4) * 2 + (c >> 5), rr = r & 15, cc = c & 31, ob = rr * 64 + cc * 2; return st * 1024 + (ob ^ (((ob >> 9) & 1) << 5)); }
__host__ __device__ __forceinline__ void stage_rc(int b, int& R, int& C) { const int st = b / 1024, sb = b % 1024, swz = sb ^ (((sb >> 9) & 1) << 5); R = (st >> 1) * 16 + swz / 64; C = (st & 1) * 32 + (swz % 64) / 2; }
__host__ __device__ __forceinline__ int perm32(int rho) { const int n = rho >> 4, i = rho & 15; return 8 * (i >> 2) + 4 * n + (i & 3); }

struct Unit { int pm, pn, seg; };
struct Gemm { const bf16_t* A; const bf16_t* Bt; const bf16_t* A2; const bf16_t* Bt2; int lda, ldb, K; };

struct StaticOrder {
    int nM, nN, nwg, G, c;
    __host__ __device__ void init(int M, int N, int G_, int c_) { nM = M / BM; nN = N / BM; nwg = nM * nN; G = G_; c = c_; }
    __host__ __device__ bool next(int i, Unit& u) const {
        const long L = (long)i * G + c; if (L >= nwg) return false;
        int wgid = (int)L; { const int q = nwg / NXCD, r = nwg % NXCD, xcd = wgid % NXCD, off = wgid / NXCD; wgid = (xcd < r ? xcd * (q + 1) : r * (q + 1) + (xcd - r) * q) + off; }
        const int nig = WGM * nN, gid = wgid / nig, fm = gid * WGM, gsz = (nM - fm) < WGM ? (nM - fm) : WGM;
        u.pm = fm + ((wgid % nig) % gsz); u.pn = (wgid % nig) / gsz; u.seg = 0; return true;
    }
    __device__ __forceinline__ void a_ready(const Unit&) const {}
    __device__ __forceinline__ void done(const Unit&) const {}
};
struct ChainOrder {
    StaticOrder so;
    __host__ __device__ bool next(int i, Unit& u) const { if (!so.next(i >> 1, u)) return false; u.seg = i & 1; return true; }
    __device__ __forceinline__ void a_ready(const Unit&) const {}
    __device__ __forceinline__ void done(const Unit&) const {}
};

__device__ __forceinline__ unsigned cvt_pk_bf16(float lo, float hi) { unsigned r; asm volatile("v_cvt_pk_bf16_f32 %0, %1, %2" : "=v"(r) : "v"(lo), "v"(hi)); return r; }
__device__ __forceinline__ float bf_lo(unsigned w) { return __uint_as_float(w << 16); }
__device__ __forceinline__ float bf_hi(unsigned w) { return __uint_as_float(w & 0xffff0000u); }
__device__ __forceinline__ float sigmoidf_fast(float x) { return __builtin_amdgcn_rcpf(1.0f + __builtin_amdgcn_exp2f(-1.4426950408889634f * x)); }
constexpr int HLD = 6400;
constexpr int H_Q = 0, H_K = 1024, H_V = 1152, H_AG = 1280, H_PIN = 2304, H_PG = 3328, H_MA = 4352, H_MP = 5376;
constexpr float QSCALE = 0.125f * 1.4426950408889634f;

struct EpiH {
    static constexpr bool PERM = true, AFTER_DRAIN = false, CHAIN = false;
    bf16_t* H;
    __device__ __forceinline__ void operator()(f32x4 (&acc)[2][2][4][2], const Unit& u, int wr, int wc, int fr, int fq) const {
        const int row0 = u.pm * BM + wr * 64 + fr, col0 = u.pn * BM + wc * 32 + 8 * fq;
        const int mode = (u.pn < 4) ? 1 : ((u.pn >= 17) ? 2 : 0);
#pragma unroll
        for (int ai = 0; ai < 2; ++ai)
#pragma unroll
            for (int m = 0; m < 4; ++m) { bf16_t* rowp = H + (size_t)(row0 + ai * HALF + m * 16) * HLD + col0;
#pragma unroll
                for (int bj = 0; bj < 2; ++bj) { f32x4 v0 = acc[ai][bj][m][0], v1 = acc[ai][bj][m][1];
                    if (mode == 1) { v0 = v0 * QSCALE; v1 = v1 * QSCALE; }
                    else if (mode == 2) {
#pragma unroll
                        for (int e = 0; e < 4; ++e) { v0[e] = sigmoidf_fast(v0[e]); v1[e] = sigmoidf_fast(v1[e]); } }
                    u32x4 w; w.x = cvt_pk_bf16(v0[0], v0[1]); w.y = cvt_pk_bf16(v0[2], v0[3]); w.z = cvt_pk_bf16(v1[0], v1[1]); w.w = cvt_pk_bf16(v1[2], v1[3]);
                    *(u32x4*)(rowp + bj * HALF) = w; } }
    }
};
struct EpiChain {
    static constexpr bool PERM = true, AFTER_DRAIN = false, CHAIN = true;
    bf16_t* H;
    __device__ __forceinline__ void operator()(f32x4 (&acc)[2][2][4][2], const Unit& u, int wr, int wc, int fr, int fq) const {
        const int row0 = u.pm * BM + wr * 64 + fr, col0 = u.pn * BM + wc * 32 + 8 * fq;
#pragma unroll
        for (int ai = 0; ai < 2; ++ai)
#pragma unroll
            for (int m = 0; m < 4; ++m) { bf16_t* rowp = H + (size_t)(row0 + ai * HALF + m * 16) * HLD + col0;
#pragma unroll
                for (int bj = 0; bj < 2; ++bj) {
                    const u32x4 sp = *(const u32x4*)(rowp + H_MP + bj * HALF);
                    float p[8] = {bf_lo(sp.x), bf_hi(sp.x), bf_lo(sp.y), bf_hi(sp.y), bf_lo(sp.z), bf_hi(sp.z), bf_lo(sp.w), bf_hi(sp.w)};
                    if (u.seg == 0) {
                        const u32x4 sa = *(const u32x4*)(rowp + H_MA + bj * HALF);
                        const float a[8] = {bf_lo(sa.x), bf_hi(sa.x), bf_lo(sa.y), bf_hi(sa.y), bf_lo(sa.z), bf_hi(sa.z), bf_lo(sa.w), bf_hi(sa.w)};
#pragma unroll
                        for (int e = 0; e < 4; ++e) { acc[ai][bj][m][0][e] *= a[e] * __builtin_amdgcn_rcpf(fmaxf(p[e], 1e-18f)); acc[ai][bj][m][1][e] *= a[4 + e] * __builtin_amdgcn_rcpf(fmaxf(p[4 + e], 1e-18f)); }
                    } else {
                        f32x4 v0 = acc[ai][bj][m][0], v1 = acc[ai][bj][m][1];
#pragma unroll
                        for (int e = 0; e < 4; ++e) { v0[e] *= fmaxf(p[e], 1e-18f); v1[e] *= fmaxf(p[4 + e], 1e-18f); }
                        u32x4 w; w.x = cvt_pk_bf16(v0[0], v0[1]); w.y = cvt_pk_bf16(v0[2], v0[3]); w.z = cvt_pk_bf16(v1[0], v1[1]); w.w = cvt_pk_bf16(v1[2], v1[3]);
                        *(u32x4*)(rowp + H_AG + bj * HALF) = w; } } }
    }
};
struct EpiRes {
    static constexpr bool PERM = false, AFTER_DRAIN = false, CHAIN = false;
    const float* resid; float* out; const float* gate;
    float alpha;
    __device__ __forceinline__ void operator()(f32x4 (&acc)[2][2][4][2], const Unit& u, int wr, int wc, int fr, int fq) const {
        const int row0 = u.pm * BM + wr * 64 + fr, col0 = u.pn * BM + wc * 32 + 4 * fq;
        const float* gp = gate + (size_t)(u.pm >= 32 ? 1 : 0) * 3072 + 2048 + col0;
        f32x4 gv[2][2];
#pragma unroll
        for (int bj = 0; bj < 2; ++bj)
#pragma unroll
            for (int n = 0; n < 2; ++n) gv[bj][n] = *(const f32x4*)(gp + bj * HALF + n * 16) + 1.0f;
#pragma unroll
        for (int ai = 0; ai < 2; ++ai)
#pragma unroll
            for (int m = 0; m < 4; ++m) { const size_t off = (size_t)(row0 + ai * HALF + m * 16) * 1024 + col0;
#pragma unroll
                for (int bj = 0; bj < 2; ++bj)
#pragma unroll
                    for (int n = 0; n < 2; ++n) { const f32x4 r = *(const f32x4*)(resid + off + bj * HALF + n * 16); *(f32x4*)(out + off + bj * HALF + n * 16) = r * alpha + acc[ai][bj][m][n] * gv[bj][n]; } }
    }
};

template <class Epi, class Sched, bool ALIGN_EPI = false, bool SP2 = false>
__device__ __forceinline__ void gemm_phase(PG8_LAS unsigned char* lds, const Gemm g, const Sched& S, const Epi& E) {
    int tid_ = threadIdx.x; asm volatile("" : "+v"(tid_));
    const int tid = tid_, wid = __builtin_amdgcn_readfirstlane(tid >> 6), lane = tid & 63, wr = wid >> 2, wc = wid & 3, fr = lane & 15, fq = lane >> 4;
    const int K = g.K, nt = K / BK;
    unsigned voffA[2], voffB[2];
#pragma unroll
    for (int i = 0; i < 2; ++i) { int R, C; stage_rc(tid * 16 + i * 8192, R, C); const int Rb = Epi::PERM ? ((R & ~31) + perm32(R & 31)) : R;
        voffA[i] = (unsigned)(R * g.lda + C) * 2u; voffB[i] = (unsigned)(Rb * g.ldb + C) * 2u; }
    const size_t kstep = (size_t)(BK * 2);
    const size_t hstepA = (size_t)HALF * g.lda * 2, hstepB = (size_t)HALF * g.ldb * 2;
    const size_t tstepA = 2 * hstepA, tstepB = 2 * hstepB;
#define PG8_ABASE(u) ((const char*)((u).seg ? g.A2 : g.A) + (size_t)(u).pm * tstepA)
#define PG8_BBASE(u) ((const char*)((u).seg ? g.Bt2 : g.Bt) + (size_t)(u).pn * tstepB)
    const unsigned ldsw = (unsigned)wid * 1024u;
    const int aoff = lds_byte(wr * 64 + fr, fq * 8), boff = lds_byte(wc * 32 + fr, fq * 8);
#define PG8_SA(b, h) (((b) * 2 + (h)) * HTB)
#define PG8_SB(b, h) ((4 + (b) * 2 + (h)) * HTB)
#define PG8_STAGE(bufoff, gbase, voff) do { _Pragma("unroll") for (int _i = 0; _i < 2; ++_i) \
        __builtin_amdgcn_global_load_lds((const unsigned*)((const char*)(gbase) + (voff)[_i]), (PG8_LAS unsigned*)(lds + (bufoff) + ldsw + _i * 8192), 16, 0, 0); } while (0)
#define PG8_LDA(dst, b, h) do { _Pragma("unroll") for (int m = 0; m < 4; ++m) _Pragma("unroll") for (int k = 0; k < 2; ++k) dst[m][k] = *(const PG8_LAS bf16x8*)(lds + PG8_SA(b, h) + aoff + m * 2048 + k * 1024); } while (0)
#define PG8_LDB(dst, b, h) do { _Pragma("unroll") for (int n = 0; n < 2; ++n) _Pragma("unroll") for (int k = 0; k < 2; ++k) dst[n][k] = *(const PG8_LAS bf16x8*)(lds + PG8_SB(b, h) + boff + n * 2048 + k * 1024); } while (0)
#define PG8_MMA(ai, bj, At, Bt) do { __builtin_amdgcn_s_setprio(1); _Pragma("unroll") for (int m = 0; m < 4; ++m) _Pragma("unroll") for (int n = 0; n < 2; ++n) _Pragma("unroll") for (int k = 0; k < 2; ++k) \
        acc[ai][bj][m][n] = __builtin_amdgcn_mfma_f32_16x16x32_bf16(Bt[n][k], At[m][k], acc[ai][bj][m][n], 0, 0, 0); __builtin_amdgcn_s_setprio(0); } while (0)
#define PG8_WAIT_V(n) asm volatile("s_waitcnt vmcnt(" #n ")" ::: "memory")
#define PG8_WAIT_L(n) asm volatile("s_waitcnt lgkmcnt(" #n ")" ::: "memory")
#define PG8_BAR __builtin_amdgcn_s_barrier()
#define PG8_SCHED __builtin_amdgcn_sched_barrier(0)
    Unit cur, nxt; int ui = 0;
    if (!S.next(0, cur)) return;
    f32x4 acc[2][2][4][2];
#pragma unroll
    for (int a = 0; a < 2; ++a)
#pragma unroll
        for (int b = 0; b < 2; ++b)
#pragma unroll
            for (int m = 0; m < 4; ++m)
#pragma unroll
                for (int n = 0; n < 2; ++n) acc[a][b][m][n] = (f32x4){0.f, 0.f, 0.f, 0.f};
    bf16x8 At[4][2], B0[2][2], B1[2][2];
    const char* cA = PG8_ABASE(cur); const char* cB = PG8_BBASE(cur);
    S.a_ready(cur);
    if constexpr (SP2) {
        PG8_STAGE(PG8_SB(0, 0), cB, voffB); PG8_STAGE(PG8_SB(0, 1), cB + hstepB, voffB); PG8_STAGE(PG8_SA(0, 0), cA, voffA); PG8_STAGE(PG8_SA(0, 1), cA + hstepA, voffA);
        if (wr == 1) PG8_BAR;
        PG8_WAIT_V(2); PG8_BAR;
        PG8_STAGE(PG8_SB(1, 0), cB + kstep, voffB); PG8_STAGE(PG8_SA(1, 0), cA + kstep, voffA); PG8_STAGE(PG8_SB(1, 1), cB + hstepB + kstep, voffB);
        PG8_WAIT_V(6); PG8_BAR;
    } else {
        PG8_STAGE(PG8_SB(0, 0), cB, voffB); PG8_STAGE(PG8_SA(0, 0), cA, voffA); PG8_STAGE(PG8_SB(0, 1), cB + hstepB, voffB); PG8_STAGE(PG8_SA(0, 1), cA + hstepA, voffA);
        if (wr == 1) PG8_BAR;
        PG8_WAIT_V(4); PG8_BAR;
        PG8_STAGE(PG8_SB(1, 0), cB + kstep, voffB); PG8_STAGE(PG8_SA(1, 0), cA + kstep, voffA); PG8_STAGE(PG8_SB(1, 1), cB + hstepB + kstep, voffB);
        PG8_WAIT_V(6); PG8_BAR;
    }
    for (;;) {
        const bool has_next = S.next(ui + 1, nxt);
        const char* nA = has_next ? PG8_ABASE(nxt) : cA; const char* nB = has_next ? PG8_BBASE(nxt) : cB;
        for (int t = 0; t < nt; t += 2) {
            const bool last = (t == nt - 2);
            const char* a1 = cA + (size_t)(t + 1) * kstep;
            const char* a2 = last ? nA : cA + (size_t)(t + 2) * kstep; const char* b2 = last ? nB : cB + (size_t)(t + 2) * kstep;
            const char* a3 = a2 + kstep; const char* b3 = b2 + kstep;
            if (last && has_next) S.a_ready(nxt);
            if constexpr (SP2) {
            PG8_LDB(B0, 0, 0); PG8_LDB(B1, 0, 1); PG8_SCHED; PG8_LDA(At, 0, 0); PG8_STAGE(PG8_SA(1, 1), a1 + hstepA, voffA);
            PG8_WAIT_V(8); PG8_WAIT_L(0); PG8_BAR; PG8_MMA(0, 0, At, B0); PG8_MMA(0, 1, At, B1); PG8_BAR; PG8_SCHED;
            PG8_LDA(At, 0, 1); PG8_STAGE(PG8_SB(0, 0), b2, voffB); PG8_STAGE(PG8_SB(0, 1), b2 + hstepB, voffB); PG8_STAGE(PG8_SA(0, 0), a2, voffA);
            PG8_WAIT_V(8); PG8_WAIT_L(0); PG8_BAR; PG8_MMA(1, 0, At, B0); PG8_MMA(1, 1, At, B1); PG8_BAR; PG8_SCHED;
            PG8_LDB(B0, 1, 0); PG8_LDB(B1, 1, 1); PG8_SCHED; PG8_LDA(At, 1, 0); PG8_STAGE(PG8_SA(0, 1), a2 + hstepA, voffA);
            PG8_WAIT_V(8); PG8_WAIT_L(0); PG8_BAR; PG8_MMA(0, 0, At, B0); PG8_MMA(0, 1, At, B1); PG8_BAR; PG8_SCHED;
            PG8_LDA(At, 1, 1); PG8_STAGE(PG8_SB(1, 0), b3, voffB); PG8_STAGE(PG8_SB(1, 1), b3 + hstepB, voffB); PG8_STAGE(PG8_SA(1, 0), a3, voffA);
            PG8_WAIT_V(8); PG8_WAIT_L(0); PG8_BAR; PG8_MMA(1, 0, At, B0); PG8_MMA(1, 1, At, B1); PG8_BAR; PG8_SCHED;
            } else {
            PG8_LDB(B0, 0, 0); PG8_SCHED; PG8_LDA(At, 0, 0); PG8_STAGE(PG8_SA(1, 1), a1 + hstepA, voffA);
            PG8_WAIT_L(8); PG8_BAR; PG8_WAIT_L(0); PG8_MMA(0, 0, At, B0); PG8_BAR; PG8_SCHED;
            PG8_LDB(B1, 0, 1); PG8_STAGE(PG8_SB(0, 0), b2, voffB);
            PG8_BAR; PG8_WAIT_L(0); PG8_MMA(0, 1, At, B1); PG8_BAR;
            PG8_LDA(At, 0, 1); PG8_STAGE(PG8_SA(0, 0), a2, voffA);
            PG8_BAR; PG8_WAIT_L(0); PG8_MMA(1, 0, At, B0); PG8_BAR; PG8_SCHED;
            PG8_STAGE(PG8_SB(0, 1), b2 + hstepB, voffB);
            PG8_WAIT_V(6); PG8_BAR; PG8_MMA(1, 1, At, B1); PG8_BAR;
            PG8_LDB(B0, 1, 0); PG8_SCHED; PG8_LDA(At, 1, 0); PG8_STAGE(PG8_SA(0, 1), a2 + hstepA, voffA);
            PG8_WAIT_L(8); PG8_BAR; PG8_WAIT_L(0); PG8_MMA(0, 0, At, B0); PG8_BAR; PG8_SCHED;
            PG8_LDB(B1, 1, 1); PG8_STAGE(PG8_SB(1, 0), b3, voffB);
            PG8_BAR; PG8_WAIT_L(0); PG8_MMA(0, 1, At, B1); PG8_BAR;
            PG8_LDA(At, 1, 1); PG8_STAGE(PG8_SA(1, 0), a3, voffA);
            PG8_BAR; PG8_WAIT_L(0); PG8_MMA(1, 0, At, B0); PG8_BAR; PG8_SCHED;
            PG8_STAGE(PG8_SB(1, 1), b3 + hstepB, voffB);
            PG8_WAIT_V(6); PG8_BAR; PG8_MMA(1, 1, At, B1); PG8_BAR;
            }
        }
        if constexpr (ALIGN_EPI) { if (wr == 0) PG8_BAR; }
        if constexpr (!Epi::AFTER_DRAIN) { E(acc, cur, wr, wc, fr, fq); S.done(cur); }
        if (!has_next) break;
        if (!(Epi::CHAIN && cur.seg == 0))
#pragma unroll
        for (int a = 0; a < 2; ++a)
#pragma unroll
            for (int b = 0; b < 2; ++b)
#pragma unroll
                for (int m = 0; m < 4; ++m)
#pragma unroll
                    for (int n = 0; n < 2; ++n) acc[a][b][m][n] = (f32x4){0.f, 0.f, 0.f, 0.f};
        cur = nxt; cA = nA; cB = nB; ++ui;
        if constexpr (ALIGN_EPI) { if (wr == 1) PG8_BAR; }
    }
    PG8_WAIT_V(0);
    if constexpr (!ALIGN_EPI) { if (wr == 0) PG8_BAR; }
    PG8_BAR;
    if constexpr (Epi::AFTER_DRAIN) { E.fused(acc, cur, wr, wc, fr, fq, lds, wid, lane); S.done(cur); }
#undef PG8_ABASE
#undef PG8_BBASE
#undef PG8_SA
#undef PG8_SB
#undef PG8_STAGE
#undef PG8_LDA
#undef PG8_LDB
#undef PG8_MMA
#undef PG8_WAIT_V
#undef PG8_WAIT_L
#undef PG8_BAR
#undef PG8_SCHED
}
}

#ifndef PG8_SP2
#define PG8_SP2 true
#endif
#ifndef PG8_ALIGN
#define PG8_ALIGN true
#endif

namespace att {
#define ATT_LAS __attribute__((address_space(3)))
typedef short bf16x8 __attribute__((ext_vector_type(8)));
typedef short s16x4 __attribute__((ext_vector_type(4)));
typedef float f32x16 __attribute__((ext_vector_type(16)));
typedef unsigned u32x4 __attribute__((ext_vector_type(4)));
typedef unsigned u32x2 __attribute__((ext_vector_type(2)));
using pg8::HLD; using pg8::H_Q; using pg8::H_K; using pg8::H_V; using pg8::H_AG; using pg8::H_PIN; using pg8::H_PG;
using pg8::cvt_pk_bf16; using pg8::bf_lo; using pg8::bf_hi;
constexpr int SEQ = 8192;
constexpr int L_K = 0, L_V = 32768, L_TAB = 65536, TAB_N = 192, L_STG = L_TAB + 8 * TAB_N * 4, STG_ROW = 144, STG_W = 32 * STG_ROW, L_END = L_STG + 8 * STG_W;
constexpr float LOG2E = 1.4426950408889634f, NEG = -1e30f;
__device__ __forceinline__ s16x4 vtr(const ATT_LAS unsigned char* p) { return __builtin_bit_cast(s16x4, __builtin_amdgcn_ds_read_tr16_b64_v4i16((ATT_LAS s16x4*)p)); }
__device__ __forceinline__ float silu_fast(float x) { return x * __builtin_amdgcn_rcpf(1.0f + __builtin_amdgcn_exp2f(-LOG2E * x)); }
__device__ __forceinline__ int t5_bucket(int d) {
    if (d < 16) return d;
    const int v = 16 + (int)(logf((float)d / 16.0f) / 2.0794415416798357f * 16.0f);
    return v < 31 ? v : 31;
}

__device__ __forceinline__ void attn_unit(ATT_LAS unsigned char* lds, unsigned short* H, const float* __restrict__ rel_bias, const float* __restrict__ sinks_l, int b, int g, int nb) {
    int tid_ = threadIdx.x; asm volatile("" : "+v"(tid_));
    const int tid = tid_, lane = tid & 63, wid = __builtin_amdgcn_readfirstlane(tid >> 6), n = lane & 31, h = lane >> 5;
    const size_t tok0 = (size_t)b * SEQ + (size_t)nb * 128;
#pragma unroll
    for (int i = 0; i < 4; ++i) {
        const int c = tid + 512 * i, row = c >> 3, ch = c & 7;
        u32x4 kv = (u32x4){0u, 0u, 0u, 0u}, vv = (u32x4){0u, 0u, 0u, 0u};
        if (nb > 0 || row >= 128) { const unsigned short* src = H + (tok0 + row - 128) * HLD + H_K + g * 64 + ch * 8; kv = *(const u32x4*)src; vv = *(const u32x4*)(src + 128); }
        *(ATT_LAS u32x4*)(lds + L_K + row * 128 + ((ch ^ ((row >> 1) & 7)) << 4)) = kv;
        *(ATT_LAS u32x4*)(lds + L_V + row * 128 + ((ch * 16) ^ (((row >> 1) & 1) << 6))) = vv;
    }
    for (int e = tid; e < 8 * TAB_N; e += 512) {
        const int hl = e / TAB_N, j = e - hl * TAB_N, d = 159 - j;
        float v = NEG;
        if (d >= 0 && d < 128) v = rel_bias[t5_bucket(d) * 16 + g * 8 + hl] * LOG2E;
        ((ATT_LAS float*)(lds + L_TAB))[e] = v;
    }
    __syncthreads();
    const int hd = g * 8 + wid;
    const float sink2 = sinks_l[hd] * LOG2E;
    const ATT_LAS float* tab = (const ATT_LAS float*)(lds + L_TAB + wid * (TAB_N * 4)) + (31 - n + 4 * h);
    unsigned koff[4];
#pragma unroll
    for (int st = 0; st < 4; ++st) koff[st] = (unsigned)(n * 128 + (((2 * st + h) ^ ((n >> 1) & 7)) << 4));
    const int q4 = (lane & 15) >> 2, p4 = lane & 3, blk = (lane >> 4) & 1;
    const ATT_LAS unsigned char* vb[2];
#pragma unroll
    for (int db = 0; db < 2; ++db) vb[db] = lds + L_V + ((4 * h + q4) * 128 + ((db * 64 + blk * 32 + p4 * 8) ^ ((q4 >> 1) << 6)));
    ATT_LAS unsigned char* stg = lds + L_STG + wid * STG_W;
#pragma unroll 1
    for (int sb = 0; sb < 4; ++sb) {
        const size_t qtok = tok0 + (size_t)sb * 32;
        const unsigned short* qp = H + (qtok + n) * HLD + H_Q + hd * 64 + 8 * h;
        bf16x8 qf[4];
#pragma unroll
        for (int st = 0; st < 4; ++st) qf[st] = *(const bf16x8*)(qp + 16 * st);
        u32x4 gt[4];
#pragma unroll
        for (int it = 0; it < 4; ++it) gt[it] = *(const u32x4*)(H + (qtok + it * 8 + (lane >> 3)) * HLD + H_AG + hd * 64 + (lane & 7) * 8);
        f32x16 s[5];
#pragma unroll
        for (int kbi = 0; kbi < 5; ++kbi) {
            if (nb == 0 && sb + kbi < 4) {
#pragma unroll
                for (int r = 0; r < 16; ++r) s[kbi][r] = NEG;
            } else {
#pragma unroll
                for (int r = 0; r < 16; ++r) s[kbi][r] = tab[32 * kbi + (r & 3) + 8 * (r >> 2)];
                const ATT_LAS unsigned char* kp = lds + L_K + (sb + kbi) * 4096;
#pragma unroll
                for (int st = 0; st < 4; ++st) { const bf16x8 kf = *(const ATT_LAS bf16x8*)(kp + koff[st]); s[kbi] = __builtin_amdgcn_mfma_f32_32x32x16_bf16(kf, qf[st], s[kbi], 0, 0, 0); }
            }
        }
        float mx = sink2;
#pragma unroll
        for (int kbi = 0; kbi < 5; ++kbi)
#pragma unroll
            for (int r = 0; r < 16; ++r) mx = fmaxf(mx, s[kbi][r]);
        mx = fmaxf(mx, __shfl_xor(mx, 32));
        float lsum = 0.f;
#pragma unroll
        for (int kbi = 0; kbi < 5; ++kbi)
#pragma unroll
            for (int r = 0; r < 16; ++r) { const float p = __builtin_amdgcn_exp2f(s[kbi][r] - mx); s[kbi][r] = p; lsum += p; }
        lsum += __shfl_xor(lsum, 32);
        lsum += __builtin_amdgcn_exp2f(sink2 - mx);
        const float inv = 1.0f / lsum;
        u32x4 pk[5][2];
#pragma unroll
        for (int kbi = 0; kbi < 5; ++kbi)
#pragma unroll
            for (int s2 = 0; s2 < 2; ++s2) { pk[kbi][s2].x = cvt_pk_bf16(s[kbi][8 * s2 + 0], s[kbi][8 * s2 + 1]); pk[kbi][s2].y = cvt_pk_bf16(s[kbi][8 * s2 + 2], s[kbi][8 * s2 + 3]);
                                             pk[kbi][s2].z = cvt_pk_bf16(s[kbi][8 * s2 + 4], s[kbi][8 * s2 + 5]); pk[kbi][s2].w = cvt_pk_bf16(s[kbi][8 * s2 + 6], s[kbi][8 * s2 + 7]); }
        f32x16 o[2];
#pragma unroll
        for (int db = 0; db < 2; ++db) {
#pragma unroll
            for (int r = 0; r < 16; ++r) o[db][r] = 0.f;
#pragma unroll
            for (int kbi = 0; kbi < 5; ++kbi)
#pragma unroll
                for (int s2 = 0; s2 < 2; ++s2) {
                    const ATT_LAS unsigned char* va = vb[db] + ((sb + kbi) * 32 + 16 * s2) * 128;
                    const s16x4 lo = vtr(va), hi = vtr(va + 8 * 128);
                    const bf16x8 vf = (bf16x8){lo[0], lo[1], lo[2], lo[3], hi[0], hi[1], hi[2], hi[3]};
                    o[db] = __builtin_amdgcn_mfma_f32_32x32x16_bf16(vf, __builtin_bit_cast(bf16x8, pk[kbi][s2]), o[db], 0, 0, 0);
                }
        }
#pragma unroll
        for (int db = 0; db < 2; ++db)
#pragma unroll
            for (int i = 0; i < 4; ++i) { u32x2 w; w.x = cvt_pk_bf16(o[db][4 * i + 0] * inv, o[db][4 * i + 1] * inv); w.y = cvt_pk_bf16(o[db][4 * i + 2] * inv, o[db][4 * i + 3] * inv);
                *(ATT_LAS u32x2*)(stg + n * STG_ROW + (db * 32 + 8 * i + 4 * h) * 2) = w; }
#pragma unroll
        for (int it = 0; it < 4; ++it) {
            const int row = it * 8 + (lane >> 3), ch = lane & 7;
            const u32x4 ov = *(const ATT_LAS u32x4*)(stg + row * STG_ROW + ch * 16);
            const u32x4 gv = gt[it];
            u32x4 w;
            w.x = cvt_pk_bf16(bf_lo(ov.x) * silu_fast(bf_lo(gv.x)), bf_hi(ov.x) * silu_fast(bf_hi(gv.x)));
            w.y = cvt_pk_bf16(bf_lo(ov.y) * silu_fast(bf_lo(gv.y)), bf_hi(ov.y) * silu_fast(bf_hi(gv.y)));
            w.z = cvt_pk_bf16(bf_lo(ov.z) * silu_fast(bf_lo(gv.z)), bf_hi(ov.z) * silu_fast(bf_hi(gv.z)));
            w.w = cvt_pk_bf16(bf_lo(ov.w) * silu_fast(bf_lo(gv.w)), bf_hi(ov.w) * silu_fast(bf_hi(gv.w)));
            *(u32x4*)(H + (qtok + row) * HLD + H_Q + hd * 64 + ch * 8) = w;
        }
    }
    __syncthreads();
}

__device__ __forceinline__ void pool_item(unsigned short* H, int item, int lane) {
    const int grp = item & 3, rp = item >> 2, w = 2 << grp;
    const int t0 = rp * 32 + (lane >> 5) * 16, s0 = t0 & (SEQ - 1), col = grp * 256 + (lane & 31) * 8;
    const unsigned short* pin = H + (size_t)t0 * HLD + H_PIN + col;
    unsigned short* pg = H + (size_t)t0 * HLD + H_PG + col;
    float sum[8];
#pragma unroll
    for (int e = 0; e < 8; ++e) sum[e] = 0.f;
    if (s0 > 0) {
        for (int i = 1; i < w; ++i) { const u32x4 v = *(const u32x4*)(pin - (size_t)i * HLD);
            sum[0] += bf_lo(v.x); sum[1] += bf_hi(v.x); sum[2] += bf_lo(v.y); sum[3] += bf_hi(v.y); sum[4] += bf_lo(v.z); sum[5] += bf_hi(v.z); sum[6] += bf_lo(v.w); sum[7] += bf_hi(v.w); }
    }
#pragma unroll 4
    for (int j = 0; j < 16; ++j) {
        const u32x4 cv = *(const u32x4*)(pin + (size_t)j * HLD);
        const u32x4 gv = *(const u32x4*)(pg + (size_t)j * HLD);
        const float cur[8] = {bf_lo(cv.x), bf_hi(cv.x), bf_lo(cv.y), bf_hi(cv.y), bf_lo(cv.z), bf_hi(cv.z), bf_lo(cv.w), bf_hi(cv.w)};
        const float gt[8] = {bf_lo(gv.x), bf_hi(gv.x), bf_lo(gv.y), bf_hi(gv.y), bf_lo(gv.z), bf_hi(gv.z), bf_lo(gv.w), bf_hi(gv.w)};
        const int cnt = (s0 + j + 1 < w) ? (s0 + j + 1) : w;
        const float ic = 1.0f / (float)cnt;
        float o[8];
#pragma unroll
        for (int e = 0; e < 8; ++e) { sum[e] += cur[e]; o[e] = (sum[e] * ic - cur[e]) * silu_fast(gt[e]); }
        u32x4 wv; wv.x = cvt_pk_bf16(o[0], o[1]); wv.y = cvt_pk_bf16(o[2], o[3]); wv.z = cvt_pk_bf16(o[4], o[5]); wv.w = cvt_pk_bf16(o[6], o[7]);
        *(u32x4*)(pg + (size_t)j * HLD) = wv;
        if (s0 + j - (w - 1) >= 0) { const u32x4 v = *(const u32x4*)(pin + ((ptrdiff_t)j - (w - 1)) * HLD);
            sum[0] -= bf_lo(v.x); sum[1] -= bf_hi(v.x); sum[2] -= bf_lo(v.y); sum[3] -= bf_hi(v.y); sum[4] -= bf_lo(v.z); sum[5] -= bf_hi(v.z); sum[6] -= bf_lo(v.w); sum[7] -= bf_hi(v.w); }
    }
}
}

constexpr int NWAVES = 8;
constexpr int BATCH = 2, SEQ = 8192, D = 1024, M = BATCH * SEQ, NIN = 6400, DEPTH = 2;
constexpr float LN_EPS = 1e-5f;
constexpr float DN_ALPHA = 1.4142135623730951f;
constexpr size_t MiB = 1u << 20;
constexpr size_t WS_CTL = 0, CTL_ZERO_BYTES = 65536;
constexpr size_t WS_MOD = 65536;
constexpr size_t WS_WIN = 1 * MiB;
constexpr size_t WS_WAP = WS_WIN + (size_t)NIN * D * 2;
constexpr size_t WS_WPP = WS_WAP + 2 * MiB, WS_WOUT = WS_WPP + 2 * MiB;
constexpr size_t WS_U = 20 * MiB;
constexpr size_t WS_H = 52 * MiB;
constexpr size_t WS_END = WS_H + (size_t)M * NIN * 2;
static_assert(WS_WOUT + 2 * MiB <= WS_U && WS_U + (size_t)M * D * 2 <= WS_H && WS_END <= 256 * MiB, "d_ws map");
constexpr int CW_BAR = 4096;
constexpr int RING_BYTES = 131072, LDSCTL_OFF = RING_BYTES, MISC_OFF = LDSCTL_OFF + 320, LDS_BYTES = 147456;
static_assert(att::L_END <= RING_BYTES && MISC_OFF + 128 <= LDS_BYTES, "LDS map");

#define GAS __attribute__((address_space(1)))
#define LAS __attribute__((address_space(3)))
typedef unsigned short bf16;
typedef unsigned v4u __attribute__((ext_vector_type(4)));
typedef float f32x4 __attribute__((ext_vector_type(4)));
typedef float f32x16 __attribute__((ext_vector_type(16)));
typedef GAS unsigned gu32;
#define RLX_AGENT __ATOMIC_RELAXED, __HIP_MEMORY_SCOPE_AGENT
#define LDS_WAIT() asm volatile("s_waitcnt lgkmcnt(0)" ::: "memory")
#define VM_WAIT() asm volatile("s_waitcnt vmcnt(0)" ::: "memory")
__device__ __forceinline__ unsigned long long rt() { return __builtin_amdgcn_s_memrealtime(); }
__device__ __forceinline__ unsigned f2bf(float f) { unsigned u = __builtin_bit_cast(unsigned, f); return (u + 0x7fffu + ((u >> 16) & 1u)) >> 16; }
__device__ __forceinline__ unsigned pk2(float lo, float hi) { return f2bf(lo) | (f2bf(hi) << 16); }

#define XB_TMO      128
#define XB_XCNT(j)  (256  + 64 * (j))
#define XB_XSUB(j)  (1280 + 64 * (j))
#define XB_XGEN(j)  (2304 + 64 * (j))
#define XB_TOP      3328
#define XB_TOPGEN   3392
#define XCD_BAR_WORDS 3456
#define XB_SPIN_CAP (1u << 18)

__device__ __forceinline__ unsigned xb_ld(unsigned* p)              { return __hip_atomic_load(p, __ATOMIC_RELAXED, __HIP_MEMORY_SCOPE_AGENT); }
__device__ __forceinline__ unsigned xb_add(unsigned* p, unsigned v) { return __hip_atomic_fetch_add(p, v, __ATOMIC_RELAXED, __HIP_MEMORY_SCOPE_AGENT); }
__device__ __forceinline__ unsigned xb_xcc_id() { return (unsigned)__builtin_amdgcn_s_getreg((3 << 11) | 20) & 0xFu; }
#define XB_SPIN(cond, bar) do { unsigned _sp = 0; while (cond) { __builtin_amdgcn_s_sleep(1); \
    if ((++_sp & 255u) == 0u) { if (xb_ld(&(bar)[XB_TMO])) break; if (_sp > XB_SPIN_CAP) { atomicAdd(&(bar)[XB_TMO], 1u); break; } } } } while (0)

struct XcdBarrier {
    unsigned* bar; unsigned x;
    volatile LAS unsigned* st;
};

__device__ __forceinline__ XcdBarrier xcd_barrier_post(unsigned* bar, volatile LAS unsigned* st) {
    XcdBarrier b; b.bar = bar; b.x = xb_xcc_id(); b.st = st;
    if (threadIdx.x == 0) (void)xb_add(&bar[XB_XCNT(b.x)], 1u);
    return b;
}
__device__ __forceinline__ void xcd_barrier_complete(unsigned* bar, unsigned x, unsigned& nloc, unsigned& nx) {
    const unsigned G = gridDim.x * gridDim.y * gridDim.z;
    unsigned sum, cnt, mine, sp = 0u;
    for (;;) {
        sum = 0u; cnt = 0u; mine = 0u;
#pragma unroll
        for (unsigned j = 0; j < 16; ++j) { const unsigned c = xb_ld(&bar[XB_XCNT(j)]); sum += c; cnt += (c > 0u) ? 1u : 0u; mine = (j == x) ? c : mine; }
        if (sum == G) break;
        __builtin_amdgcn_s_sleep(1);
        if ((++sp & 255u) == 0u) { if (xb_ld(&bar[XB_TMO])) break; if (sp > XB_SPIN_CAP) { atomicAdd(&bar[XB_TMO], 1u); break; } }
    }
    nloc = mine > 0u ? mine : 1u; nx = cnt > 0u ? cnt : 1u;
}

__device__ __forceinline__ void xcd_barrier(const XcdBarrier& b) {
    asm volatile("s_waitcnt vmcnt(0)" ::: "memory");
    __syncthreads();
    if (threadIdx.x == 0) {
        unsigned* bar = b.bar;
        __builtin_amdgcn_s_waitcnt(0);
        unsigned nloc = b.st[0], nx = b.st[1];
        if (nloc == 0u) { xcd_barrier_complete(bar, b.x, nloc, nx); b.st[0] = nloc; b.st[1] = nx; }
        const unsigned old = xb_add(&bar[XB_XSUB(b.x)], 1u);
        const unsigned gen = old / nloc;
        if (old + 1u == (gen + 1u) * nloc) {
            __builtin_amdgcn_fence(__ATOMIC_RELEASE, "agent");
            asm volatile("s_waitcnt vmcnt(0)" ::: "memory");
            const unsigned og = xb_add(&bar[XB_TOP], 1u);
            const unsigned tg = og / nx;
            if (og + 1u == (tg + 1u) * nx) xb_add(&bar[XB_TOPGEN], 1u);
            else XB_SPIN(xb_ld(&bar[XB_TOPGEN]) == tg, bar);
            __builtin_amdgcn_fence(__ATOMIC_ACQUIRE, "agent");
            xb_add(&bar[XB_XGEN(b.x)], 1u);
            asm volatile("s_waitcnt vmcnt(0)" ::: "memory");
        } else {
            XB_SPIN(xb_ld(&bar[XB_XGEN(b.x)]) == gen, bar);
            __builtin_amdgcn_fence(__ATOMIC_ACQUIRE, "agent");
            asm volatile("s_waitcnt vmcnt(0)" ::: "memory");
        }
    }
    __syncthreads();
}


__device__ __forceinline__ float wave_sum(float v) {
#pragma unroll
    for (int o = 1; o < 64; o <<= 1) v += __shfl_xor(v, o);
    return v;
}
__device__ __forceinline__ void p0_transpose_item(const float* W, int K, int N, bf16* WT, int row_off, LAS float* scr, int item, int lane) {
    const int nblk = N / 32, kb = item / nblk, nb = item % nblk, k0 = 64 * kb, n0 = 32 * nb;
#pragma unroll 8
    for (int i = 0; i < 32; ++i) { const int kk = 2 * i + (lane >> 5); scr[kk * 33 + (lane & 31)] = W[(size_t)(k0 + kk) * N + n0 + (lane & 31)]; }
    LDS_WAIT(); asm volatile("" ::: "memory");
    const int c = lane & 7;
#pragma unroll
    for (int j = 0; j < 4; ++j) { const int n = (lane >> 3) + 8 * j; const LAS float* s = scr + (8 * c) * 33 + n;
        v4u o; o.x = pk2(s[0 * 33], s[1 * 33]); o.y = pk2(s[2 * 33], s[3 * 33]); o.z = pk2(s[4 * 33], s[5 * 33]); o.w = pk2(s[6 * 33], s[7 * 33]);
        *(GAS v4u*)(WT + (size_t)(row_off + n0 + n) * K + k0 + 8 * c) = o; }
    LDS_WAIT(); asm volatile("" ::: "memory");
}
__device__ __forceinline__ void merge_item(const float* w_in_l, const float* w_mix_l, const float* ps_l, bf16* WinT, int mi, int lane) {
    const int nb32 = mi >> 5, kb32 = mi & 31, n0 = 32 * nb32, g = n0 >> 8, d0 = n0 & 255, kin0 = 32 * kb32;
    const int i = lane & 31, h = lane >> 5;
    const float* Ap = w_mix_l + (size_t)g * 65536 + d0 + i;
    const float* Bp = w_in_l + (size_t)(kin0 + i) * NIN + 2304 + g * 256;
    f32x16 acc;
#pragma unroll
    for (int r = 0; r < 16; ++r) acc[r] = 0.f;
#pragma unroll 4
    for (int t = 0; t < 64; ++t) {
        const float a_lo = Ap[(size_t)(4 * t + h) * 256], a_hi = Ap[(size_t)(4 * t + 2 + h) * 256];
        const f32x4 bq = *(const f32x4*)(Bp + 4 * t);
        const float b_lo = h ? bq[1] : bq[0], b_hi = h ? bq[3] : bq[2];
        acc = __builtin_amdgcn_mfma_f32_32x32x2f32(a_lo, b_lo, acc, 0, 0, 0);
        acc = __builtin_amdgcn_mfma_f32_32x32x2f32(a_hi, b_hi, acc, 0, 0, 0);
    }
#pragma unroll
    for (int r = 0; r < 16; ++r) { const int n = n0 + (r & 3) + 8 * (r >> 2) + 4 * h;
        WinT[(size_t)(2304 + n) * D + kin0 + i] = (bf16)f2bf(acc[r] * ps_l[n]); }
}
__device__ __forceinline__ void conv_weights(const float* w_in_l, const float* w_mix_l, const float* ps_l, const float* w_ap_l, const float* w_pp_l, const float* w_out_l,
                                             bf16* WinT, bf16* WapT, bf16* WppT, bf16* WoutT, LAS float* scr, int gw, int NGW, int lane) {
    constexpr int I_IN = (D / 64) * (NIN / 32), I_SQ = (D / 64) * (D / 32), I_MG = 1024, NITEMS = I_MG + I_IN + 3 * I_SQ;
    for (int it = gw; it < NITEMS; it += NGW) {
        int r = it;
        if (r < I_MG) { merge_item(w_in_l, w_mix_l, ps_l, WinT, r, lane); continue; } r -= I_MG;
        if (r < I_IN) { const int nb = r % (NIN / 32); if (nb >= 72 && nb < 104) continue; p0_transpose_item(w_in_l, D, NIN, WinT, 0, scr, r, lane); continue; } r -= I_IN;
        if (r < I_SQ) { p0_transpose_item(w_ap_l, D, D, WapT, 0, scr, r, lane); continue; } r -= I_SQ;
        if (r < I_SQ) { p0_transpose_item(w_pp_l, D, D, WppT, 0, scr, r, lane); continue; } r -= I_SQ;
        p0_transpose_item(w_out_l, D, D, WoutT, 0, scr, r, lane);
    }
}
__device__ __forceinline__ void mod_phase(const float* c, const float* w_ada, const float* b_ada, float* mod, LAS float* red, int wg, int tid) {
    const int l = wg / 96, j0 = 32 * (wg % 96);
    const int lane = tid & 63, wv = tid >> 6, cg = lane & 7, ks = lane >> 3;
    const float* W = w_ada + (size_t)l * D * 3072 + j0 + 4 * cg;
    f32x4 a0 = (f32x4){0.f, 0.f, 0.f, 0.f}, a1 = (f32x4){0.f, 0.f, 0.f, 0.f};
#pragma unroll 4
    for (int i = 0; i < 16; ++i) {
        const int k = 128 * wv + ks + 8 * i;
        const f32x4 w4 = *(const f32x4*)(W + (size_t)k * 3072);
        const float c0 = c[k], c1 = c[D + k];
        const float s0 = c0 / (1.0f + __expf(-c0)), s1 = c1 / (1.0f + __expf(-c1));
        a0 += w4 * s0; a1 += w4 * s1;
    }
#pragma unroll
    for (int e = 0; e < 4; ++e) {
        a0[e] += __shfl_xor(a0[e], 8); a0[e] += __shfl_xor(a0[e], 16); a0[e] += __shfl_xor(a0[e], 32);
        a1[e] += __shfl_xor(a1[e], 8); a1[e] += __shfl_xor(a1[e], 16); a1[e] += __shfl_xor(a1[e], 32);
    }
    if (ks == 0) {
#pragma unroll
        for (int e = 0; e < 4; ++e) { red[(wv * 2 + 0) * 32 + 4 * cg + e] = a0[e]; red[(wv * 2 + 1) * 32 + 4 * cg + e] = a1[e]; }
    }
    __syncthreads();
    if (tid < 64) { const int b = tid >> 5, col = tid & 31; float s = b_ada[l * 3072 + j0 + col];
#pragma unroll
        for (int w2 = 0; w2 < 8; ++w2) s += red[(w2 * 2 + b) * 32 + col];
        mod[(size_t)(l * 2 + b) * 3072 + j0 + col] = s; }
    __syncthreads();
}
__device__ __forceinline__ void u_row(const float* xrow, const float* modrow, bf16* urow, int lane) {
#pragma unroll
    for (int j = 0; j < 4; ++j) { const int col = 4 * lane + 256 * j;
        const f32x4 x4 = *(const f32x4*)(xrow + col), sh = *(const f32x4*)(modrow + col), sc = *(const f32x4*)(modrow + 1024 + col);
        const f32x4 u = x4 * (sc + 1.0f) + sh;
        *(unsigned long long*)(urow + col) = (unsigned long long)pk2(u[0], u[1]) | ((unsigned long long)pk2(u[2], u[3]) << 32); }
}
__device__ __forceinline__ void ln_row(float* vrow, const float* gain, const float* bias, const float* modnext, bf16* urow, int lane) {
    f32x4 v[4]; float s = 0.f;
#pragma unroll
    for (int j = 0; j < 4; ++j) { v[j] = *(const f32x4*)(vrow + 4 * lane + 256 * j); s += (v[j][0] + v[j][1]) + (v[j][2] + v[j][3]); }
    const float mean = wave_sum(s) * (1.f / D); float s2 = 0.f;
#pragma unroll
    for (int j = 0; j < 4; ++j) { v[j] = v[j] - mean; s2 += (v[j][0] * v[j][0] + v[j][1] * v[j][1]) + (v[j][2] * v[j][2] + v[j][3] * v[j][3]); }
    const float rstd = 1.f / sqrtf(wave_sum(s2) * (1.f / D) + LN_EPS);
#pragma unroll
    for (int j = 0; j < 4; ++j) { const int col = 4 * lane + 256 * j;
        const f32x4 y = v[j] * rstd * *(const f32x4*)(gain + col) + *(const f32x4*)(bias + col);
        *(f32x4*)(vrow + col) = y;
        if (modnext) { const f32x4 u = y * (*(const f32x4*)(modnext + 1024 + col) + 1.0f) + *(const f32x4*)(modnext + col);
            *(unsigned long long*)(urow + col) = (unsigned long long)pk2(u[0], u[1]) | ((unsigned long long)pk2(u[2], u[3]) << 32); } }
}

struct Args { const float* in[14]; float* out; unsigned char* ws; };
__global__ void __launch_bounds__(NWAVES * 64, 2) trunk_fwd(Args args) {
    extern __shared__ __attribute__((aligned(16))) unsigned char lds_raw[];
    LAS unsigned char* lds = (LAS unsigned char*)lds_raw;
    volatile LAS unsigned* MISC = (volatile LAS unsigned*)(lds + MISC_OFF);
    const int tid = threadIdx.x, lane = tid & 63, wave = __builtin_amdgcn_readfirstlane(tid >> 6);
    const int G = gridDim.x, bx = blockIdx.x, gw = bx * NWAVES + wave, NGW = G * NWAVES;
    const float* x = args.in[0]; const float* cvec = args.in[1]; const float* rel_bias = args.in[2]; const float* w_ada = args.in[3]; const float* b_ada = args.in[4];
    const float* w_in = args.in[5]; const float* sinks = args.in[6]; const float* w_mix = args.in[7]; const float* pscale = args.in[8];
    const float* w_ap = args.in[9]; const float* w_pp = args.in[10]; const float* w_out = args.in[11]; const float* ln_gain = args.in[12]; const float* ln_bias = args.in[13];
    float* out = args.out; unsigned char* ws = args.ws;
    gu32* ctl = (gu32*)(ws + WS_CTL);
    float* mod = (float*)(ws + WS_MOD);
    bf16* WinT = (bf16*)(ws + WS_WIN); bf16* WapT = (bf16*)(ws + WS_WAP); bf16* WppT = (bf16*)(ws + WS_WPP); bf16* WoutT = (bf16*)(ws + WS_WOUT);
    bf16* U = (bf16*)(ws + WS_U); bf16* H = (bf16*)(ws + WS_H);
    for (int u = tid; u < (LDS_BYTES - LDSCTL_OFF) / 4; u += NWAVES * 64) ((LAS unsigned*)(lds + LDSCTL_OFF))[u] = 0u;
    __syncthreads();
    XcdBarrier bar = xcd_barrier_post((unsigned*)(ctl + CW_BAR), MISC + 8);
    LAS float* scr = (LAS float*)(lds + wave * 16384);

    if (bx < 192) mod_phase(cvec, w_ada, b_ada, mod, (LAS float*)(lds + 12288), bx, tid);
    conv_weights(w_in, w_mix, pscale, w_ap, w_pp, w_out, WinT, WapT, WppT, WoutT, scr, gw, NGW, lane);
    xcd_barrier(bar);
    for (int m = gw; m < M; m += NGW) u_row(x + (size_t)m * D, mod + (size_t)(m >= SEQ ? 1 : 0) * 3072, U + (size_t)m * D, lane);
    xcd_barrier(bar);

#pragma unroll 1
    for (int l = 0; l < DEPTH; ++l) {
        int bxl = bx, lanel = lane; asm volatile("" : "+s"(bxl)); asm volatile("" : "+v"(lanel));
        const int gwl = bxl * NWAVES + wave;
        { pg8::Gemm g{U, WinT, nullptr, nullptr, D, D, D}; pg8::StaticOrder S; S.init(M, NIN, G, bxl); pg8::EpiH E{H};
          pg8::gemm_phase<pg8::EpiH, pg8::StaticOrder, PG8_ALIGN, PG8_SP2>(lds, g, S, E); }
        xcd_barrier(bar);
        for (int u = bxl; u < 256; u += G) att::attn_unit(lds, H, rel_bias, sinks + l * 16, u >> 7, (u >> 6) & 1, u & 63);
        for (int it = gwl; it < 2048; it += NGW) att::pool_item(H, it, lanel);
        xcd_barrier(bar);
        { pg8::Gemm g{H + pg8::H_Q, WapT, H + pg8::H_PG, WppT, pg8::HLD, D, D}; pg8::ChainOrder S; S.so.init(M, D, G, bxl); pg8::EpiChain E{H};
          pg8::gemm_phase<pg8::EpiChain, pg8::ChainOrder, PG8_ALIGN, PG8_SP2>(lds, g, S, E); }
        xcd_barrier(bar);
        { pg8::Gemm g{H + pg8::H_AG, WoutT, nullptr, nullptr, pg8::HLD, D, D}; pg8::StaticOrder S; S.init(M, D, G, bxl);
          pg8::EpiRes E{l == 0 ? x : (const float*)out, out, mod + (size_t)l * 2 * 3072, DN_ALPHA};
          pg8::gemm_phase<pg8::EpiRes, pg8::StaticOrder, PG8_ALIGN, PG8_SP2>(lds, g, S, E); }
        xcd_barrier(bar);
        for (int m = gwl; m < M; m += NGW)
            ln_row(out + (size_t)m * D, ln_gain + l * D, ln_bias + l * D, l == 0 ? mod + (size_t)(2 + (m >= SEQ ? 1 : 0)) * 3072 : nullptr, U + (size_t)m * D, lanel);
        if (l == 0) {
            conv_weights(w_in + (size_t)D * NIN, w_mix + 4 * 65536, pscale + D, w_ap + (size_t)D * D, w_pp + (size_t)D * D, w_out + (size_t)D * D, WinT, WapT, WppT, WoutT, scr, gwl, NGW, lanel);
            xcd_barrier(bar);
        }
    }
}

extern "C" void kernel_launch(void* const* d_in, const int* in_sizes, int n_in, void* d_out, int out_size, void* d_ws, size_t ws_size, hipStream_t stream) {
    static int grid = 0;
    if (grid == 0) {
        if (n_in != 14 || in_sizes[0] != M * D || out_size != M * D || ws_size < WS_END) { fprintf(stderr, "kernel_launch: unexpected shapes (n_in %d, in0 %d, out %d, ws %zu); nothing launched\n", n_in, n_in > 0 ? in_sizes[0] : -1, out_size, ws_size); grid = -1; return; }
        int dev = 0, cus = 0;
        if (hipGetDevice(&dev) != hipSuccess || hipDeviceGetAttribute(&cus, hipDeviceAttributeMultiprocessorCount, dev) != hipSuccess) { grid = -1; return; }
        if (hipFuncSetAttribute((const void*)trunk_fwd, hipFuncAttributeMaxDynamicSharedMemorySize, LDS_BYTES) != hipSuccess) { fprintf(stderr, "kernel_launch: hipFuncSetAttribute failed\n"); grid = -1; return; }
        (void)hipGetLastError();
        grid = cus;
    }
    if (grid < 0) return;
    if (hipMemsetAsync((char*)d_ws + WS_CTL, 0, CTL_ZERO_BYTES, stream) != hipSuccess) return;
    Args a{};
    for (int i = 0; i < 14; ++i) a.in[i] = (const float*)d_in[i];
    a.out = (float*)d_out; a.ws = (unsigned char*)d_ws;
    hipLaunchKernelGGL(trunk_fwd, dim3(grid), dim3(NWAVES * 64), LDS_BYTES, stream, a);
}
```
